# Optimizing an MI355X kernel written in HIP

```python
import jax, jax.numpy as jnp
from jax import lax
import numpy as np

D_MODEL = 1024
BATCH = 4
SEQ = 4096
DEPTH = 2
DEC_BATCH = 128
DEC_SEQ = 8
PAST_LEN = 8192
PAGE_SIZE = 128

N_EVEN = (DEPTH + 1) // 2
N_ODD = DEPTH // 2
HEAD_DIM = 64
A_WIDTH = D_MODEL // 2
B_WIDTH = D_MODEL // 2
C_WIDTH = D_MODEL // 2
D_WIDTH = D_MODEL // 2
CONV_A = 3
CONV_B = 31
POOL_WINDOWS = (2, 4, 8, 16)
POOL_GROUPS = len(POOL_WINDOWS)
POOL_GROUP_W = C_WIDTH // POOL_GROUPS
POOL_PAST = max(POOL_WINDOWS) - 1
WINDOW = 128
D_HEADS = D_WIDTH // HEAD_DIM
D_KV_HEADS = 2
D_REP = D_HEADS // D_KV_HEADS
KV_WIDTH = D_KV_HEADS * HEAD_DIM
EVEN_SPLITS = (A_WIDTH, A_WIDTH, A_WIDTH, A_WIDTH, B_WIDTH, B_WIDTH, B_WIDTH)
ODD_SPLITS = (C_WIDTH, C_WIDTH, D_WIDTH, KV_WIDTH, KV_WIDTH, D_WIDTH)
EVEN_IN = sum(EVEN_SPLITS)
ODD_IN = sum(ODD_SPLITS)
MIX_EVEN = A_WIDTH + B_WIDTH
MIX_ODD = C_WIDTH + D_WIDTH
RMS_EPS = 1e-6
LN_EPS = 1e-5

kernel_name = "hybrid_conv_pool_swa_decoder_step"


def split_cols(z, sizes):
    idx = [int(i) for i in np.cumsum(sizes)[:-1]]
    return jnp.split(z, idx, axis=-1)


def rms_norm(x, g):
    x32 = x.astype(jnp.float32)
    y = x32 * lax.rsqrt(jnp.mean(x32 * x32, axis=-1, keepdims=True) + RMS_EPS)
    return (y * g.astype(jnp.float32)).astype(x.dtype)


def layer_norm(x, g, b):
    x32 = x.astype(jnp.float32)
    mu = jnp.mean(x32, axis=-1, keepdims=True)
    xc = x32 - mu
    var = jnp.mean(xc * xc, axis=-1, keepdims=True)
    y = xc * lax.rsqrt(var + LN_EPS) * g.astype(jnp.float32) + b.astype(jnp.float32)
    return y.astype(x.dtype)


def adaln(c, w_mod, b_mod):
    mod = jax.nn.silu(c) @ w_mod + b_mod
    return jnp.split(mod[:, None, :], 3, axis=-1)


def causal_dwconv(u, past, w):
    full = jnp.concatenate([past.astype(u.dtype), u], axis=1)
    y = lax.conv_general_dilated(full, w[:, None, :].astype(u.dtype), window_strides=(1,), padding="VALID",
                                 dimension_numbers=("NWC", "WIO", "NWC"), feature_group_count=u.shape[-1])
    return y, full[:, -(w.shape[0] - 1):]


def multiscale_pool(u, past, pool_w, pool_scale, pos0):
    n, t, ch = u.shape
    full = jnp.concatenate([past.astype(u.dtype), u], axis=1)
    csum = jnp.cumsum(full.astype(jnp.float32), axis=1)
    csum = jnp.concatenate([jnp.zeros((n, 1, ch), jnp.float32), csum], axis=1)
    end = csum[:, POOL_PAST + 1:]
    pos = pos0 + jnp.arange(t)
    u32 = u.astype(jnp.float32)
    outs = []
    for g, w in enumerate(POOL_WINDOWS):
        sl = slice(g * POOL_GROUP_W, (g + 1) * POOL_GROUP_W)
        start = csum[:, POOL_PAST + 1 - w:POOL_PAST + 1 - w + t, sl]
        cnt = jnp.minimum(w, pos + 1).astype(jnp.float32)[None, :, None]
        outs.append((end[..., sl] - start) / cnt - u32[..., sl])
    pooled = jnp.stack(outs, axis=2)
    mixed = jnp.einsum("ntgc,gcd->ntgd", pooled, pool_w.astype(jnp.float32)).reshape(n, t, ch)
    return (mixed * pool_scale.astype(jnp.float32)).astype(u.dtype), full[:, -POOL_PAST:]


def window_attention(q, k, v, past_k, past_v, sinks, pos0):
    n, t, _, hd = q.shape
    nb = -(-t // WINDOW)
    tp = nb * WINDOW
    kf = jnp.concatenate([past_k.astype(k.dtype), k], axis=1)
    vf = jnp.concatenate([past_v.astype(v.dtype), v], axis=1)
    new_k, new_v = kf[:, -WINDOW:], vf[:, -WINDOW:]
    padk = ((0, 0), (0, tp - t), (0, 0), (0, 0))
    kb = jnp.pad(kf, padk).reshape(n, nb + 1, WINDOW, D_KV_HEADS, hd)
    vb = jnp.pad(vf, padk).reshape(n, nb + 1, WINDOW, D_KV_HEADS, hd)
    kband = jnp.concatenate([kb[:, :-1], kb[:, 1:]], axis=2).astype(jnp.float32)
    vband = jnp.concatenate([vb[:, :-1], vb[:, 1:]], axis=2).astype(jnp.float32)
    qb = jnp.pad(q, padk).reshape(n, nb, WINDOW, D_KV_HEADS, D_REP, hd).astype(jnp.float32)
    s = jnp.einsum("nbqgrd,nbkgd->nbgrqk", qb, kband) * (hd ** -0.5)
    qi = jnp.arange(tp).reshape(nb, WINDOW)
    kj = jnp.arange(nb)[:, None] * WINDOW + jnp.arange(2 * WINDOW)[None, :]
    t_abs = pos0 + qi
    s_abs = pos0 - WINDOW + kj
    dist = t_abs[:, :, None] - s_abs[:, None, :]
    valid = (dist >= 0) & (dist < WINDOW) & (s_abs[:, None, :] >= 0) & (kj[:, None, :] < WINDOW + t)
    slopes = jnp.asarray(2.0 ** (-8.0 * np.arange(1, D_HEADS + 1) / D_HEADS), jnp.float32)
    slopes = slopes.reshape(1, 1, D_KV_HEADS, D_REP, 1, 1)
    s = s - slopes * dist.astype(jnp.float32)[None, :, None, None]
    s = jnp.where(valid[None, :, None, None], s, -jnp.inf)
    sink = sinks.astype(jnp.float32).reshape(1, 1, D_KV_HEADS, D_REP, 1, 1)
    m = jnp.maximum(jnp.max(s, axis=-1, keepdims=True), sink)
    p = jnp.exp(s - m)
    p = p / (jnp.sum(p, axis=-1, keepdims=True) + jnp.exp(sink - m))
    o = jnp.einsum("nbgrqk,nbkgd->nbqgrd", p, vband).reshape(n, tp, D_HEADS * hd)[:, :t]
    return o.astype(q.dtype), new_k, new_v


def even_layer(x, c, st_a, st_b, w_mod, b_mod, g_pre, g_post, w_in, conv_a_w, conv_b_w, conv_b_b,
               ln_g, ln_b, w_out):
    shift, scale, gate = adaln(c, w_mod, b_mod)
    h = rms_norm(x, g_pre) * (1 + scale) + shift
    a_x, a_b, a_c, a_gate, b_val, b_glu, b_gate = split_cols(h @ w_in, EVEN_SPLITS)
    ya, new_a = causal_dwconv(a_c * a_x, st_a, conv_a_w)
    ya = a_b * ya * jax.nn.silu(a_gate)
    ub = b_val * jax.nn.sigmoid(b_glu)
    yb, new_b = causal_dwconv(ub, st_b, conv_b_w)
    yb = jax.nn.silu(layer_norm(yb + conv_b_b, ln_g, ln_b)) * jax.nn.silu(b_gate)
    mix = jnp.concatenate([ya, yb], axis=-1) @ w_out
    return x + gate * rms_norm(mix, g_post), new_a, new_b


def odd_layer(x, c, st_c, st_k, st_v, pos0, w_mod, b_mod, g_pre, g_post, w_in, pool_w, pool_scale,
              sinks, w_out):
    n, t, _ = x.shape
    shift, scale, gate = adaln(c, w_mod, b_mod)
    h = rms_norm(x, g_pre) * (1 + scale) + shift
    c_u, c_gate, q, k, v, d_gate = split_cols(h @ w_in, ODD_SPLITS)
    yc, new_c = multiscale_pool(c_u, st_c, pool_w, pool_scale, pos0)
    yc = yc * jax.nn.silu(c_gate)
    yd, new_k, new_v = window_attention(q.reshape(n, t, D_HEADS, HEAD_DIM),
                                        k.reshape(n, t, D_KV_HEADS, HEAD_DIM),
                                        v.reshape(n, t, D_KV_HEADS, HEAD_DIM), st_k, st_v, sinks, pos0)
    yd = yd * jax.nn.silu(d_gate)
    mix = jnp.concatenate([yc, yd], axis=-1) @ w_out
    return x + gate * rms_norm(mix, g_post), new_c, new_k, new_v


def trunk(x, c, st_a, st_b, st_c, st_k, st_v, pos0, we, wo):
    na, nbs, nc, nk, nv = [], [], [], [], []
    for layer in range(DEPTH):
        i = layer // 2
        if layer % 2 == 0:
            x, sa, sb = even_layer(x, c, st_a[i], st_b[i], *[w[i] for w in we])
            na.append(sa)
            nbs.append(sb)
        else:
            x, sc, sk, sv = odd_layer(x, c, st_c[i], st_k[i], st_v[i], pos0, *[w[i] for w in wo])
            nc.append(sc)
            nk.append(sk)
            nv.append(sv)
    return x, jnp.stack(na), jnp.stack(nbs), jnp.stack(nc), jnp.stack(nk), jnp.stack(nv)


def setup_inputs(seed: int = 0) -> dict:
    key = jax.random.key(seed)
    ks = iter(jax.random.split(key, 40))

    def nrm(shape, s=1.0):
        return s * jax.random.normal(next(ks), shape, jnp.float32)

    d = D_MODEL
    return {
        "x_prompt": nrm((BATCH, SEQ, d)),
        "x_sample": nrm((DEC_BATCH, DEC_SEQ, d)),
        "state_conv_a": nrm((N_EVEN, DEC_BATCH, CONV_A - 1, A_WIDTH)),
        "state_conv_b": nrm((N_EVEN, DEC_BATCH, CONV_B - 1, B_WIDTH)),
        "state_pool_c": nrm((N_ODD, DEC_BATCH, POOL_PAST, C_WIDTH)),
        "cache_win_k": nrm((N_ODD, DEC_BATCH, WINDOW, D_KV_HEADS, HEAD_DIM)),
        "cache_win_v": nrm((N_ODD, DEC_BATCH, WINDOW, D_KV_HEADS, HEAD_DIM)),
        "c_prompt": nrm((BATCH, d)),
        "c_sample": nrm((DEC_BATCH, d)),
        "w_mod_e": nrm((N_EVEN, d, 3 * d), d ** -0.5),
        "b_mod_e": nrm((N_EVEN, 3 * d), 0.02),
        "g_pre_e": 1.0 + nrm((N_EVEN, d), 0.1),
        "g_post_e": 1.0 + nrm((N_EVEN, d), 0.1),
        "w_in_e": nrm((N_EVEN, d, EVEN_IN), d ** -0.5),
        "conv_a_w": nrm((N_EVEN, CONV_A, A_WIDTH), CONV_A ** -0.5),
        "conv_b_w": nrm((N_EVEN, CONV_B, B_WIDTH), CONV_B ** -0.5),
        "conv_b_b": nrm((N_EVEN, B_WIDTH), 0.02),
        "ln_b_g": 1.0 + nrm((N_EVEN, B_WIDTH), 0.1),
        "ln_b_b": nrm((N_EVEN, B_WIDTH), 0.02),
        "w_out_e": nrm((N_EVEN, MIX_EVEN, d), MIX_EVEN ** -0.5),
        "w_mod_o": nrm((N_ODD, d, 3 * d), d ** -0.5),
        "b_mod_o": nrm((N_ODD, 3 * d), 0.02),
        "g_pre_o": 1.0 + nrm((N_ODD, d), 0.1),
        "g_post_o": 1.0 + nrm((N_ODD, d), 0.1),
        "w_in_o": nrm((N_ODD, d, ODD_IN), d ** -0.5),
        "pool_w": nrm((N_ODD, POOL_GROUPS, POOL_GROUP_W, POOL_GROUP_W), POOL_GROUP_W ** -0.5),
        "pool_scale": 1.0 + nrm((N_ODD, C_WIDTH), 0.1),
        "sinks": nrm((N_ODD, D_HEADS)),
        "w_out_o": nrm((N_ODD, MIX_ODD, d), MIX_ODD ** -0.5),
    }


def reference(x_prompt, x_sample, state_conv_a, state_conv_b, state_pool_c, cache_win_k, cache_win_v,
              c_prompt, c_sample, w_mod_e, b_mod_e, g_pre_e, g_post_e, w_in_e, conv_a_w, conv_b_w, conv_b_b,
              ln_b_g, ln_b_b, w_out_e, w_mod_o, b_mod_o, g_pre_o, g_post_o, w_in_o, pool_w, pool_scale,
              sinks, w_out_o):
    we = (w_mod_e, b_mod_e, g_pre_e, g_post_e, w_in_e, conv_a_w, conv_b_w, conv_b_b, ln_b_g, ln_b_b, w_out_e)
    wo = (w_mod_o, b_mod_o, g_pre_o, g_post_o, w_in_o, pool_w, pool_scale, sinks, w_out_o)
    dt = x_prompt.dtype
    z_a = jnp.zeros((N_EVEN, BATCH, CONV_A - 1, A_WIDTH), dt)
    z_b = jnp.zeros((N_EVEN, BATCH, CONV_B - 1, B_WIDTH), dt)
    z_c = jnp.zeros((N_ODD, BATCH, POOL_PAST, C_WIDTH), dt)
    z_kv = jnp.zeros((N_ODD, BATCH, WINDOW, D_KV_HEADS, HEAD_DIM), dt)
    y_prompt, pa, pb, pc, pk, pv = trunk(x_prompt, c_prompt, z_a, z_b, z_c, z_kv, z_kv, 0, we, wo)
    y_sample, sa, sb, sc, sk, sv = trunk(x_sample, c_sample, state_conv_a, state_conv_b, state_pool_c,
                                         cache_win_k, cache_win_v, PAST_LEN, we, wo)
    return (y_prompt, y_sample, pa, sa, pb, sb, pc, sc, pk, sk, pv, sv)
```

```cpp
#include <hip/hip_runtime.h>
#include <cstdio>
#include <cstdint>
namespace pg8 {
#define PG8_LAS __attribute__((address_space(3)))
typedef unsigned short bf16_t;
typedef short bf16x8 __attribute__((ext_vector_type(8)));
typedef float f32x4 __attribute__((ext_vector_type(4)));
typedef unsigned u32x4 __attribute__((ext_vector_type(4)));
constexpr int BM = 256, BK = 64, HALF = 128, HTB = HALF * BK * 2  , STAGE_BYTES = 8 * HTB, NXCD = 8, WGM = 8;

__host__ __device__ __forceinline__ int lds_byte(int r, int c) { const int st = (r >> 4) * 2 + (c >> 5), rr = r & 15, cc = c & 31, ob = rr * 64 + cc * 2; return st * 1024 + (ob ^ (((ob >> 9) & 1) << 5)); }
__host__ __device__ __forceinline__ void stage_rc(int b, int& R, int& C) { const int st = b / 1024, sb = b % 1024, swz = sb ^ (((sb >> 9) & 1) << 5); R = (st >> 1) * 16 + swz / 64; C = (st & 1) * 32 + (swz % 64) / 2; }
__host__ __device__ __forceinline__ int perm32(int rho) { const int n = rho >> 4, i = rho & 15; return 8 * (i >> 2) + 4 * n + (i & 3); }

struct Unit { int pm, pn; };
struct Gemm { const bf16_t* A; const bf16_t* Bt; int M, N, K; };

struct StaticOrder {
    int nM, nN, nwg, G, c;
    __host__ __device__ void init(int M, int N, int G_, int c_) { nM = M / BM; nN = N / BM; nwg = nM * nN; G = G_; c = c_; }
    __host__ __device__ bool next(int i, Unit& u) const {
        const long L = (long)i * G + c; if (L >= nwg) return false;
        int wgid = (int)L; { const int q = nwg / NXCD, r = nwg % NXCD, xcd = wgid % NXCD, off = wgid / NXCD; wgid = (xcd < r ? xcd * (q + 1) : r * (q + 1) + (xcd - r) * q) + off; }
        const int nig = WGM * nN, gid = wgid / nig, fm = gid * WGM, gsz = (nM - fm) < WGM ? (nM - fm) : WGM;
        u.pm = fm + ((wgid % nig) % gsz); u.pn = (wgid % nig) / gsz; return true;
    }
    __device__ __forceinline__ void a_ready(const Unit&) const {}
    __device__ __forceinline__ void done(const Unit&) const {}
};

__device__ __forceinline__ unsigned cvt_pk_bf16(float lo, float hi) { unsigned r; asm volatile("v_cvt_pk_bf16_f32 %0, %1, %2" : "=v"(r) : "v"(lo), "v"(hi)); return r; }
__device__ __forceinline__ float ep_sigm(float v) { return __builtin_amdgcn_rcpf(1.f + __expf(-v)); }
__device__ __forceinline__ float ep_silu(float v) { return v * ep_sigm(v); }
__device__ __forceinline__ u32x4 pack8(const f32x4 a, const f32x4 b) { u32x4 w; w.x = cvt_pk_bf16(a[0], a[1]); w.y = cvt_pk_bf16(a[2], a[3]); w.z = cvt_pk_bf16(b[0], b[1]); w.w = cvt_pk_bf16(b[2], b[3]); return w; }
__device__ __forceinline__ f32x4 silu4(const f32x4 a) { return (f32x4){ep_silu(a[0]), ep_silu(a[1]), ep_silu(a[2]), ep_silu(a[3])}; }
__device__ __forceinline__ f32x4 sigm4(const f32x4 a) { return (f32x4){ep_sigm(a[0]), ep_sigm(a[1]), ep_sigm(a[2]), ep_sigm(a[3])}; }

struct EpiPlain {
    static constexpr bool PERM = false, AFTER_DRAIN = false;
    bf16_t* O; int ldc;
    __device__ __forceinline__ void operator()(const f32x4 (&acc)[2][2][4][2], const Unit& u, int wr, int wc, int fr, int fq) const {
        const int row0 = u.pm * BM + wr * 64 + fr, col0 = u.pn * BM + wc * 32 + 8 * fq;
#pragma unroll
        for (int ai = 0; ai < 2; ++ai)
#pragma unroll
            for (int m = 0; m < 4; ++m) { bf16_t* rowp = O + (size_t)(row0 + ai * HALF + m * 16) * ldc + col0;
#pragma unroll
                for (int bj = 0; bj < 2; ++bj) *(u32x4*)(rowp + bj * HALF) = pack8(acc[ai][bj][m][0], acc[ai][bj][m][1]); }
    }
};
struct EpiG1 {
    static constexpr bool PERM = false, AFTER_DRAIN = false;
    bf16_t* A; size_t stride;
    __device__ __forceinline__ void operator()(const f32x4 (&acc)[2][2][4][2], const Unit& u, int wr, int wc, int fr, int fq) const {
        const int row0 = u.pm * BM + wr * 64 + fr;
        if (u.pn < 12) {
            const int kind = u.pn >> 2, col0 = (u.pn & 3) * 128 + wc * 32 + 8 * fq;
            bf16_t* dst = A + (size_t)kind * stride;
#pragma unroll
            for (int ai = 0; ai < 2; ++ai)
#pragma unroll
                for (int m = 0; m < 4; ++m) {
                    f32x4 v0, v1;
                    if (kind == 0)      { v0 = acc[ai][0][m][0] * acc[ai][1][m][0];        v1 = acc[ai][0][m][1] * acc[ai][1][m][1]; }
                    else if (kind == 1) { v0 = acc[ai][0][m][0] * silu4(acc[ai][1][m][0]); v1 = acc[ai][0][m][1] * silu4(acc[ai][1][m][1]); }
                    else                { v0 = acc[ai][0][m][0] * sigm4(acc[ai][1][m][0]); v1 = acc[ai][0][m][1] * sigm4(acc[ai][1][m][1]); }
                    *(u32x4*)(dst + (size_t)(row0 + ai * HALF + m * 16) * 512 + col0) = pack8(v0, v1);
                }
        } else {
            const int col0 = (u.pn - 12) * BM + wc * 32 + 8 * fq;
#pragma unroll
            for (int ai = 0; ai < 2; ++ai)
#pragma unroll
                for (int m = 0; m < 4; ++m) { bf16_t* rowp = A + 3 * stride + (size_t)(row0 + ai * HALF + m * 16) * 512 + col0;
#pragma unroll
                    for (int bj = 0; bj < 2; ++bj) *(u32x4*)(rowp + bj * HALF) = pack8(silu4(acc[ai][bj][m][0]), silu4(acc[ai][bj][m][1])); }
        }
    }
};
struct EpiG3 {
    static constexpr bool PERM = false, AFTER_DRAIN = false;
    bf16_t *A, *K, *VT; size_t stride; int vt_ld; float qscale;
    __device__ __forceinline__ void operator()(const f32x4 (&acc)[2][2][4][2], const Unit& u, int wr, int wc, int fr, int fq) const {
        const int row0 = u.pm * BM + wr * 64 + fr;
        if (u.pn == 6) {
            const int c0 = wc * 32 + 8 * fq;
#pragma unroll
            for (int ai = 0; ai < 2; ++ai)
#pragma unroll
                for (int m = 0; m < 4; ++m) { const int row = row0 + ai * HALF + m * 16;
                    *(u32x4*)(K + (size_t)row * 128 + c0) = pack8(acc[ai][0][m][0], acc[ai][0][m][1]);
                    const u32x4 w = pack8(acc[ai][1][m][0], acc[ai][1][m][1]);
                    bf16_t* vp = VT + (size_t)c0 * vt_ld + row;
                    vp[0] = (bf16_t)(w.x & 0xffffu); vp[(size_t)vt_ld] = (bf16_t)(w.x >> 16); vp[(size_t)2 * vt_ld] = (bf16_t)(w.y & 0xffffu); vp[(size_t)3 * vt_ld] = (bf16_t)(w.y >> 16);
                    vp[(size_t)4 * vt_ld] = (bf16_t)(w.z & 0xffffu); vp[(size_t)5 * vt_ld] = (bf16_t)(w.z >> 16); vp[(size_t)6 * vt_ld] = (bf16_t)(w.w & 0xffffu); vp[(size_t)7 * vt_ld] = (bf16_t)(w.w >> 16);
                }
            return;
        }
        const int mode = (u.pn == 2 || u.pn == 3 || u.pn >= 7) ? 1 : ((u.pn == 4 || u.pn == 5) ? 2 : 0);
        bf16_t* dst = A + (size_t)(u.pn < 2 ? 0 : (u.pn < 4 ? 1 : (u.pn < 6 ? 2 : 3))) * stride;
        const int pl = u.pn < 2 ? u.pn : (u.pn < 4 ? u.pn - 2 : (u.pn < 6 ? u.pn - 4 : u.pn - 7));
        const int col0 = pl * BM + wc * 32 + 8 * fq;
#pragma unroll
        for (int ai = 0; ai < 2; ++ai)
#pragma unroll
            for (int m = 0; m < 4; ++m) { bf16_t* rowp = dst + (size_t)(row0 + ai * HALF + m * 16) * 512 + col0;
#pragma unroll
                for (int bj = 0; bj < 2; ++bj) { f32x4 v0 = acc[ai][bj][m][0], v1 = acc[ai][bj][m][1];
                    if (mode == 1) { v0 = silu4(v0); v1 = silu4(v1); } else if (mode == 2) { v0 = v0 * qscale; v1 = v1 * qscale; }
                    *(u32x4*)(rowp + bj * HALF) = pack8(v0, v1); } }
    }
};

template <class Epi, class Sched, bool ALIGN_EPI = false, bool SP2 = false>
__device__ __forceinline__ void gemm_phase(PG8_LAS unsigned char* lds, const Gemm g, const Sched& S, const Epi& E) {
    const int tid = threadIdx.x, wid = __builtin_amdgcn_readfirstlane(tid >> 6), lane = tid & 63, wr = wid >> 2, wc = wid & 3, fr = lane & 15, fq = lane >> 4;
    const int K = g.K, nt = K / BK;
    unsigned voffA[2], voffB[2];
#pragma unroll
    for (int i = 0; i < 2; ++i) { int R, C; stage_rc(tid * 16 + i * 8192, R, C); const int Rb = Epi::PERM ? ((R & ~31) + perm32(R & 31)) : R;
        voffA[i] = (unsigned)(R * K + C) * 2u; voffB[i] = (unsigned)(Rb * K + C) * 2u; }
    const size_t kstep = (size_t)(BK * 2);
    const size_t hstep = (size_t)HALF * K * 2;
    const size_t tstep = 2 * hstep;
    const unsigned ldsw = (unsigned)wid * 1024u;
    const int aoff = lds_byte(wr * 64 + fr, fq * 8), boff = lds_byte(wc * 32 + fr, fq * 8);
#define PG8_SA(b, h) (((b) * 2 + (h)) * HTB)
#define PG8_SB(b, h) ((4 + (b) * 2 + (h)) * HTB)
#define PG8_STAGE(bufoff, gbase, voff) do { _Pragma("unroll") for (int _i = 0; _i < 2; ++_i) \
        __builtin_amdgcn_global_load_lds((const unsigned*)((const char*)(gbase) + (voff)[_i]), (PG8_LAS unsigned*)(lds + (bufoff) + ldsw + _i * 8192), 16, 0, 0); } while (0)
#define PG8_LDA(dst, b, h) do { _Pragma("unroll") for (int m = 0; m < 4; ++m) _Pragma("unroll") for (int k = 0; k < 2; ++k) dst[m][k] = *(const PG8_LAS bf16x8*)(lds + PG8_SA(b, h) + aoff + m * 2048 + k * 1024); } while (0)
#define PG8_LDB(dst, b, h) do { _Pragma("unroll") for (int n = 0; n < 2; ++n) _Pragma("unroll") for (int k = 0; k < 2; ++k) dst[n][k] = *(const PG8_LAS bf16x8*)(lds + PG8_SB(b, h) + boff + n * 2048 + k * 1024); } while (0)
#define PG8_MMA(ai, bj, At, Bt) do { __builtin_amdgcn_s_setprio(1); _Pragma("unroll") for (int m = 0; m < 4; ++m) _Pragma("unroll") for (int n = 0; n < 2; ++n) _Pragma("unroll") for (int k = 0; k < 2; ++k) \
        acc[ai][bj][m][n] = __builtin_amdgcn_mfma_f32_16x16x32_bf16(Bt[n][k], At[m][k], acc[ai][bj][m][n], 0, 0, 0); __builtin_amdgcn_s_setprio(0); } while (0)
#define PG8_WAIT_V(n) asm volatile("s_waitcnt vmcnt(" #n ")" ::: "memory")
#define PG8_WAIT_L(n) asm volatile("s_waitcnt lgkmcnt(" #n ")" ::: "memory")
#define PG8_BAR __builtin_amdgcn_s_barrier()
#define PG8_SCHED __builtin_amdgcn_sched_barrier(0)
    Unit cur, nxt; int ui = 0;
    if (!S.next(0, cur)) return;
    f32x4 acc[2][2][4][2];
#pragma unroll
    for (int a = 0; a < 2; ++a)
#pragma unroll
        for (int b = 0; b < 2; ++b)
#pragma unroll
            for (int m = 0; m < 4; ++m)
#pragma unroll
                for (int n = 0; n < 2; ++n) acc[a][b][m][n] = (f32x4){0.f, 0.f, 0.f, 0.f};
    bf16x8 At[4][2], B0[2][2], B1[2][2];
    const char* cA = (const char*)g.A + (size_t)cur.pm * tstep; const char* cB = (const char*)g.Bt + (size_t)cur.pn * tstep;
    S.a_ready(cur);
    if constexpr (SP2) {
        PG8_STAGE(PG8_SB(0, 0), cB, voffB); PG8_STAGE(PG8_SB(0, 1), cB + hstep, voffB); PG8_STAGE(PG8_SA(0, 0), cA, voffA); PG8_STAGE(PG8_SA(0, 1), cA + hstep, voffA);
        if (wr == 1) PG8_BAR;
        PG8_WAIT_V(2); PG8_BAR;
        PG8_STAGE(PG8_SB(1, 0), cB + kstep, voffB); PG8_STAGE(PG8_SA(1, 0), cA + kstep, voffA); PG8_STAGE(PG8_SB(1, 1), cB + hstep + kstep, voffB);
        PG8_WAIT_V(6); PG8_BAR;
    } else {
        PG8_STAGE(PG8_SB(0, 0), cB, voffB); PG8_STAGE(PG8_SA(0, 0), cA, voffA); PG8_STAGE(PG8_SB(0, 1), cB + hstep, voffB); PG8_STAGE(PG8_SA(0, 1), cA + hstep, voffA);
        if (wr == 1) PG8_BAR;
        PG8_WAIT_V(4); PG8_BAR;
        PG8_STAGE(PG8_SB(1, 0), cB + kstep, voffB); PG8_STAGE(PG8_SA(1, 0), cA + kstep, voffA); PG8_STAGE(PG8_SB(1, 1), cB + hstep + kstep, voffB);
        PG8_WAIT_V(6); PG8_BAR;
    }
    for (;;) {
        const bool has_next = S.next(ui + 1, nxt);
        const char* nA = has_next ? (const char*)g.A + (size_t)nxt.pm * tstep : cA; const char* nB = has_next ? (const char*)g.Bt + (size_t)nxt.pn * tstep : cB;
        for (int t = 0; t < nt; t += 2) {
            const bool last = (t == nt - 2);
            const char* a1 = cA + (size_t)(t + 1) * kstep;
            const char* a2 = last ? nA : cA + (size_t)(t + 2) * kstep; const char* b2 = last ? nB : cB + (size_t)(t + 2) * kstep;
            const char* a3 = a2 + kstep; const char* b3 = b2 + kstep;
            if (last && has_next) S.a_ready(nxt);
            if constexpr (SP2) {
            PG8_LDB(B0, 0, 0); PG8_LDB(B1, 0, 1); PG8_SCHED; PG8_LDA(At, 0, 0); PG8_STAGE(PG8_SA(1, 1), a1 + hstep, voffA);
            PG8_WAIT_V(8); PG8_WAIT_L(0); PG8_BAR; PG8_MMA(0, 0, At, B0); PG8_MMA(0, 1, At, B1); PG8_BAR; PG8_SCHED;
            PG8_LDA(At, 0, 1); PG8_STAGE(PG8_SB(0, 0), b2, voffB); PG8_STAGE(PG8_SB(0, 1), b2 + hstep, voffB); PG8_STAGE(PG8_SA(0, 0), a2, voffA);
            PG8_WAIT_V(8); PG8_WAIT_L(0); PG8_BAR; PG8_MMA(1, 0, At, B0); PG8_MMA(1, 1, At, B1); PG8_BAR; PG8_SCHED;
            PG8_LDB(B0, 1, 0); PG8_LDB(B1, 1, 1); PG8_SCHED; PG8_LDA(At, 1, 0); PG8_STAGE(PG8_SA(0, 1), a2 + hstep, voffA);
            PG8_WAIT_V(8); PG8_WAIT_L(0); PG8_BAR; PG8_MMA(0, 0, At, B0); PG8_MMA(0, 1, At, B1); PG8_BAR; PG8_SCHED;
            PG8_LDA(At, 1, 1); PG8_STAGE(PG8_SB(1, 0), b3, voffB); PG8_STAGE(PG8_SB(1, 1), b3 + hstep, voffB); PG8_STAGE(PG8_SA(1, 0), a3, voffA);
            PG8_WAIT_V(8); PG8_WAIT_L(0); PG8_BAR; PG8_MMA(1, 0, At, B0); PG8_MMA(1, 1, At, B1); PG8_BAR; PG8_SCHED;
            } else {
            PG8_LDB(B0, 0, 0); PG8_SCHED; PG8_LDA(At, 0, 0); PG8_STAGE(PG8_SA(1, 1), a1 + hstep, voffA);
            PG8_WAIT_L(8); PG8_BAR; PG8_WAIT_L(0); PG8_MMA(0, 0, At, B0); PG8_BAR; PG8_SCHED;
            PG8_LDB(B1, 0, 1); PG8_STAGE(PG8_SB(0, 0), b2, voffB);
            PG8_BAR; PG8_WAIT_L(0); PG8_MMA(0, 1, At, B1); PG8_BAR;
            PG8_LDA(At, 0, 1); PG8_STAGE(PG8_SA(0, 0), a2, voffA);
            PG8_BAR; PG8_WAIT_L(0); PG8_MMA(1, 0, At, B0); PG8_BAR; PG8_SCHED;
            PG8_STAGE(PG8_SB(0, 1), b2 + hstep, voffB);
            PG8_WAIT_V(6); PG8_BAR; PG8_MMA(1, 1, At, B1); PG8_BAR;
            PG8_LDB(B0, 1, 0); PG8_SCHED; PG8_LDA(At, 1, 0); PG8_STAGE(PG8_SA(0, 1), a2 + hstep, voffA);
            PG8_WAIT_L(8); PG8_BAR; PG8_WAIT_L(0); PG8_MMA(0, 0, At, B0); PG8_BAR; PG8_SCHED;
            PG8_LDB(B1, 1, 1); PG8_STAGE(PG8_SB(1, 0), b3, voffB);
            PG8_BAR; PG8_WAIT_L(0); PG8_MMA(0, 1, At, B1); PG8_BAR;
            PG8_LDA(At, 1, 1); PG8_STAGE(PG8_SA(1, 0), a3, voffA);
            PG8_BAR; PG8_WAIT_L(0); PG8_MMA(1, 0, At, B0); PG8_BAR; PG8_SCHED;
            PG8_STAGE(PG8_SB(1, 1), b3 + hstep, voffB);
            PG8_WAIT_V(6); PG8_BAR; PG8_MMA(1, 1, At, B1); PG8_BAR;
            }
        }
        if constexpr (ALIGN_EPI) { if (wr == 0) PG8_BAR; }
        if constexpr (!Epi::AFTER_DRAIN) { E(acc, cur, wr, wc, fr, fq); S.done(cur); }
        if (!has_next) break;
#pragma unroll
        for (int a = 0; a < 2; ++a)
#pragma unroll
            for (int b = 0; b < 2; ++b)
#pragma unroll
                for (int m = 0; m < 4; ++m)
#pragma unroll
                    for (int n = 0; n < 2; ++n) acc[a][b][m][n] = (f32x4){0.f, 0.f, 0.f, 0.f};
        cur = nxt; cA = nA; cB = nB; ++ui;
        if constexpr (ALIGN_EPI) { if (wr == 1) PG8_BAR; }
    }
    PG8_WAIT_V(0);
    if constexpr (!ALIGN_EPI) { if (wr == 0) PG8_BAR; }
    PG8_BAR;
    if constexpr (Epi::AFTER_DRAIN) { E.fused(acc, cur, wr, wc, fr, fq, lds, wid, lane); S.done(cur); }
#undef PG8_SA
#undef PG8_SB
#undef PG8_STAGE
#undef PG8_LDA
#undef PG8_LDB
#undef PG8_MMA
#undef PG8_WAIT_V
#undef PG8_WAIT_L
#undef PG8_BAR
#undef PG8_SCHED
}
}
#define GAS __attribute__((address_space(1)))
#define LAS __attribute__((address_space(3)))
typedef unsigned short bf16;
typedef unsigned v4u __attribute__((ext_vector_type(4)));
typedef float f32x4 __attribute__((ext_vector_type(4)));
typedef short bf16x8 __attribute__((ext_vector_type(8)));
typedef GAS unsigned gu32;
typedef GAS unsigned long long gu64;
#define RLX_AGENT __ATOMIC_RELAXED, __HIP_MEMORY_SCOPE_AGENT
#define LDS_WAIT() asm volatile("s_waitcnt lgkmcnt(0)" ::: "memory")
#define VM_WAIT() asm volatile("s_waitcnt vmcnt(0)" ::: "memory")
__device__ __forceinline__ unsigned long long rt() { return __builtin_amdgcn_s_memrealtime(); }
__device__ __forceinline__ unsigned f2bf(float f) { unsigned u = __builtin_bit_cast(unsigned, f); return (u + 0x7fffu + ((u >> 16) & 1u)) >> 16; }
__device__ __forceinline__ unsigned pk2(float lo, float hi) { return f2bf(lo) | (f2bf(hi) << 16); }

#define XB_TMO      128
#define XB_XCNT(j)  (256  + 64 * (j))
#define XB_XSUB(j)  (1280 + 64 * (j))
#define XB_XGEN(j)  (2304 + 64 * (j))
#define XB_TOP      3328
#define XB_TOPGEN   3392
#define XCD_BAR_WORDS 3456
#define XB_SPIN_CAP (1u << 18)

__device__ __forceinline__ unsigned xb_ld(unsigned* p)              { return __hip_atomic_load(p, __ATOMIC_RELAXED, __HIP_MEMORY_SCOPE_AGENT); }
__device__ __forceinline__ unsigned xb_add(unsigned* p, unsigned v) { return __hip_atomic_fetch_add(p, v, __ATOMIC_RELAXED, __HIP_MEMORY_SCOPE_AGENT); }
__device__ __forceinline__ unsigned xb_xcc_id() { return (unsigned)__builtin_amdgcn_s_getreg((3 << 11) | 20) & 0xFu; }
#define XB_SPIN(cond, bar) do { unsigned _sp = 0; while (cond) { __builtin_amdgcn_s_sleep(1); \
    if ((++_sp & 255u) == 0u) { if (xb_ld(&(bar)[XB_TMO])) break; if (_sp > XB_SPIN_CAP) { atomicAdd(&(bar)[XB_TMO], 1u); break; } } } } while (0)

struct XcdBarrier {
    unsigned* bar; unsigned x;
    volatile LAS unsigned* st;
};

__device__ __forceinline__ XcdBarrier xcd_barrier_post(unsigned* bar, volatile LAS unsigned* st) {
    XcdBarrier b; b.bar = bar; b.x = xb_xcc_id(); b.st = st;
    if (threadIdx.x == 0) (void)xb_add(&bar[XB_XCNT(b.x)], 1u);
    return b;
}
__device__ __forceinline__ void xcd_barrier_complete(unsigned* bar, unsigned x, unsigned& nloc, unsigned& nx) {
    const unsigned G = gridDim.x * gridDim.y * gridDim.z;
    unsigned sum, cnt, mine, sp = 0u;
    for (;;) {
        sum = 0u; cnt = 0u; mine = 0u;
#pragma unroll
        for (unsigned j = 0; j < 16; ++j) { const unsigned c = xb_ld(&bar[XB_XCNT(j)]); sum += c; cnt += (c > 0u) ? 1u : 0u; mine = (j == x) ? c : mine; }
        if (sum == G) break;
        __builtin_amdgcn_s_sleep(1);
        if ((++sp & 255u) == 0u) { if (xb_ld(&bar[XB_TMO])) break; if (sp > XB_SPIN_CAP) { atomicAdd(&bar[XB_TMO], 1u); break; } }
    }
    nloc = mine > 0u ? mine : 1u; nx = cnt > 0u ? cnt : 1u;
}

__device__ __forceinline__ void xcd_barrier(const XcdBarrier& b) {
    asm volatile("s_waitcnt vmcnt(0)" ::: "memory");
    __syncthreads();
    if (threadIdx.x == 0) {
        unsigned* bar = b.bar;
        __builtin_amdgcn_s_waitcnt(0);
        unsigned nloc = b.st[0], nx = b.st[1];
        if (nloc == 0u) { xcd_barrier_complete(bar, b.x, nloc, nx); b.st[0] = nloc; b.st[1] = nx; }
        const unsigned old = xb_add(&bar[XB_XSUB(b.x)], 1u);
        const unsigned gen = old / nloc;
        if (old + 1u == (gen + 1u) * nloc) {
            __builtin_amdgcn_fence(__ATOMIC_RELEASE, "agent");
            asm volatile("s_waitcnt vmcnt(0)" ::: "memory");
            const unsigned og = xb_add(&bar[XB_TOP], 1u);
            const unsigned tg = og / nx;
            if (og + 1u == (tg + 1u) * nx) xb_add(&bar[XB_TOPGEN], 1u);
            else XB_SPIN(xb_ld(&bar[XB_TOPGEN]) == tg, bar);
            __builtin_amdgcn_fence(__ATOMIC_ACQUIRE, "agent");
            xb_add(&bar[XB_XGEN(b.x)], 1u);
            asm volatile("s_waitcnt vmcnt(0)" ::: "memory");
        } else {
            XB_SPIN(xb_ld(&bar[XB_XGEN(b.x)]) == gen, bar);
            __builtin_amdgcn_fence(__ATOMIC_ACQUIRE, "agent");
            asm volatile("s_waitcnt vmcnt(0)" ::: "memory");
        }
    }
    __syncthreads();
}

constexpr int NWAVES = 8;
constexpr int DM = 1024, NB_P = 4, SEQ = 4096, NB_S = 128, TS = 8;
constexpr int MP = NB_P * SEQ, MS = NB_S * TS, MT = MP + MS, NBT = NB_P + NB_S;
constexpr int EVEN_IN = 3584, ODD_IN = 2304;
constexpr int VT_LD = MT + 64;
constexpr float RMS_EPS = 1e-6f, LNB_EPS = 1e-5f, LOG2E = 1.4426950408889634f;
constexpr size_t O_Y = 0, O_CAP = 17825792, O_CAS = O_CAP + 4096, O_CBP = O_CAS + 131072, O_CBS = O_CBP + 61440,
                 O_PCP = O_CBS + 1966080, O_PCS = O_PCP + 30720, O_WKP = O_PCS + 983040, O_WKS = O_WKP + 65536,
                 O_WVP = O_WKS + 2097152, O_WVS = O_WVP + 65536, O_END = O_WVS + 2097152;
constexpr size_t MiB = 1u << 20;
constexpr size_t WS_CTL = 0, CTL_ZERO_BYTES = 1 * MiB;
constexpr size_t WS_MODS = 1 * MiB;
constexpr size_t WS_WINE = 5 * MiB, WS_WOUTE = 12 * MiB, WS_WINO = 14 * MiB, WS_WOUTO = 19 * MiB, WS_POOLW = 21 * MiB;
constexpr size_t WS_KC = 22 * MiB, WS_VTC = 26 * MiB;
constexpr size_t WS_H = 32 * MiB, WS_MIX = 66 * MiB, WS_OUT = 100 * MiB;
constexpr size_t WS_ACT = 134 * MiB, ACT_STRIDE = 17 * MiB;
constexpr size_t WS_K = 202 * MiB, WS_VT = 207 * MiB, WS_END = 212 * MiB;
static_assert((size_t)MT * 512 * 2 == ACT_STRIDE && (size_t)MT * DM * 2 == 34 * MiB && (size_t)(MT + 64) * 128 * 2 <= 5 * MiB && (size_t)128 * VT_LD * 2 <= 5 * MiB, "ws map");
constexpr int CW_BAR = 4096;
constexpr int RING_BYTES = 131072;
constexpr int P3_STAGE = 77824, P3_LN_OFF = 77824;
constexpr int LDSCTL_OFF = 143360, MISC_OFF = LDSCTL_OFF + 320, LDS_BYTES = 147456;

typedef float f32x16 __attribute__((ext_vector_type(16)));
typedef float f32x2 __attribute__((ext_vector_type(2)));
typedef unsigned u32x2 __attribute__((ext_vector_type(2)));
__device__ __forceinline__ unsigned pkbf(float lo, float hi) { unsigned r; asm volatile("v_cvt_pk_bf16_f32 %0, %1, %2" : "=v"(r) : "v"(lo), "v"(hi)); return r; }
__device__ __forceinline__ float bf_lo(unsigned u) { return __uint_as_float(u << 16); }
__device__ __forceinline__ float bf_hi(unsigned u) { return __uint_as_float(u & 0xffff0000u); }
__device__ __forceinline__ float sigm_f(float v) { return __builtin_amdgcn_rcpf(1.f + __expf(-v)); }
__device__ __forceinline__ float silu_f(float v) { return v * sigm_f(v); }
__device__ __forceinline__ v4u pack8f(const f32x4 a, const f32x4 b) { v4u w; w.x = pkbf(a[0], a[1]); w.y = pkbf(a[2], a[3]); w.z = pkbf(b[0], b[1]); w.w = pkbf(b[2], b[3]); return w; }
__device__ __forceinline__ float wave_sum(float v) {
#pragma unroll
    for (int o = 1; o < 64; o <<= 1) v += __shfl_xor(v, o);
    return v;
}
__device__ __forceinline__ int row_batch(int m) { return m < MP ? (m >> 12) : NB_P + ((m - MP) >> 3); }
__device__ __forceinline__ int perm_in32(int c) { return 16 * ((c >> 2) & 1) + 4 * (c >> 3) + (c & 3); }

struct Frame {
    LAS unsigned char* lds;
    volatile LAS unsigned* MISC;
    gu32* ctl;
    int tid, lane, wave, vcu, G;
    const float *x_p, *x_s, *st_a, *st_b, *st_c, *ck, *cv, *c_p, *c_s;
    const float *w_mod_e, *b_mod_e, *g_pre_e, *g_post_e, *w_in_e, *conv_a_w, *conv_b_w, *conv_b_b, *ln_g, *ln_b, *w_out_e;
    const float *w_mod_o, *b_mod_o, *g_pre_o, *g_post_o, *w_in_o, *pool_w, *pool_scale, *sinks, *w_out_o;
    float* out;
    float* mods;
    bf16 *WinE, *WoutE, *WinO, *WoutO, *PoolWT, *KC, *VTC;
    bf16 *H, *MIX, *OUT, *A0, *A1, *A2, *A3, *K, *VT;
};

template <bool PERMUTE>
__device__ __forceinline__ void p0_transpose_item(const float* W, int K, int N, bf16* WT, int k0, int n0, int gbase, LAS float* scr, int lane) {
#pragma unroll 8
    for (int i = 0; i < 32; ++i) { const int kk = 2 * i + (lane >> 5); scr[kk * 33 + (lane & 31)] = W[(size_t)(k0 + kk) * N + n0 + (lane & 31)]; }
    LDS_WAIT(); asm volatile("" ::: "memory");
    const int c = lane & 7;
#pragma unroll
    for (int j = 0; j < 4; ++j) { const int n = (lane >> 3) + 8 * j; const LAS float* s = scr + (8 * c) * 33 + n;
        v4u o; o.x = pkbf(s[0 * 33], s[1 * 33]); o.y = pkbf(s[2 * 33], s[3 * 33]); o.z = pkbf(s[4 * 33], s[5 * 33]); o.w = pkbf(s[6 * 33], s[7 * 33]);
        const int row = gbase + (PERMUTE ? perm_in32(n) : n);
        *(GAS v4u*)(WT + (size_t)row * K + k0 + 8 * c) = o; }
    LDS_WAIT(); asm volatile("" ::: "memory");
}
__device__ __forceinline__ int g1_gbase(int o) {
    const int seg = o >> 9, c = o & 511;
    if (seg < 6) { const int kind = seg >= 4 ? 2 : (seg & 1), bj = seg >= 4 ? seg - 4 : (seg >> 1); return 256 * (kind * 4 + (c >> 7)) + 128 * bj + (c & 127); }
    return 256 * (12 + (c >> 8)) + (c & 255);
}
__device__ __forceinline__ void p0_mods_item(Frame& F, int item) {
    const int layer = item / 96, n0 = (item % 96) * 32, lane = F.lane, r = lane & 31, hh = lane >> 5, w = F.wave;
    const float* W = layer ? F.w_mod_o : F.w_mod_e; const float* bm = layer ? F.b_mod_o : F.b_mod_e;
    f32x16 acc[5];
#pragma unroll
    for (int mt = 0; mt < 5; ++mt) acc[mt] = (f32x16){0.f, 0.f, 0.f, 0.f, 0.f, 0.f, 0.f, 0.f, 0.f, 0.f, 0.f, 0.f, 0.f, 0.f, 0.f, 0.f};
#pragma unroll 2
    for (int s = 0; s < 8; ++s) {
        const int kk = 128 * w + 16 * s + 8 * hh;
        float bv[8];
#pragma unroll
        for (int jj = 0; jj < 8; ++jj) bv[jj] = W[(size_t)(kk + jj) * 3072 + n0 + r];
        const v4u bw = {pkbf(bv[0], bv[1]), pkbf(bv[2], bv[3]), pkbf(bv[4], bv[5]), pkbf(bv[6], bv[7])};
        const bf16x8 bfrag = __builtin_bit_cast(bf16x8, bw);
#pragma unroll
        for (int mt = 0; mt < 5; ++mt) {
            int row = 32 * mt + r; row = row > NBT - 1 ? NBT - 1 : row;
            const float* c = row < NB_P ? F.c_p + (size_t)row * DM : F.c_s + (size_t)(row - NB_P) * DM;
            const f32x4 c0 = *(const f32x4*)(c + kk), c1 = *(const f32x4*)(c + kk + 4);
            const v4u aw = {pkbf(silu_f(c0[0]), silu_f(c0[1])), pkbf(silu_f(c0[2]), silu_f(c0[3])), pkbf(silu_f(c1[0]), silu_f(c1[1])), pkbf(silu_f(c1[2]), silu_f(c1[3]))};
            acc[mt] = __builtin_amdgcn_mfma_f32_32x32x16_bf16(__builtin_bit_cast(bf16x8, aw), bfrag, acc[mt], 0, 0, 0);
        }
    }
    LAS float* red = (LAS float*)F.lds;
#define RED_ST(slot) do { _Pragma("unroll") for (int mt = 0; mt < 5; ++mt) _Pragma("unroll") for (int q = 0; q < 16; ++q) red[(slot) * 5120 + (mt * 16 + q) * 64 + lane] = acc[mt][q]; } while (0)
#define RED_LD(slot) do { _Pragma("unroll") for (int mt = 0; mt < 5; ++mt) _Pragma("unroll") for (int q = 0; q < 16; ++q) acc[mt][q] += red[(slot) * 5120 + (mt * 16 + q) * 64 + lane]; } while (0)
    if (w >= 4) RED_ST(w - 4);
    __syncthreads();
    if (w < 4) RED_LD(w);
    __syncthreads();
    if (w == 2 || w == 3) RED_ST(w - 2);
    __syncthreads();
    if (w < 2) RED_LD(w);
    __syncthreads();
    if (w == 1) RED_ST(0);
    __syncthreads();
    if (w == 0) {
        RED_LD(0);
        float* out = F.mods + (size_t)layer * NBT * 3072; const float b = bm[n0 + r];
#pragma unroll
        for (int mt = 0; mt < 5; ++mt)
#pragma unroll
            for (int q = 0; q < 16; ++q) { const int row = 32 * mt + (q & 3) + 8 * (q >> 2) + 4 * hh; if (row < NBT) out[(size_t)row * 3072 + n0 + r] = acc[mt][q] + b; }
    }
    __syncthreads();
#undef RED_ST
#undef RED_LD
}
__device__ __forceinline__ void p0_prologue(Frame& F) {
    for (int it = F.vcu; it < 192; it += F.G) p0_mods_item(F, it);
    LAS float* scr = (LAS float*)(F.lds + F.wave * 16384);
    const int gw = F.vcu * NWAVES + F.wave, NGW = F.G * NWAVES, lane = F.lane;
    constexpr int I_WIE = 16 * (EVEN_IN / 32), I_WOE = 16 * 32, I_WIO = 16 * (ODD_IN / 32), I_WOO = 16 * 32, I_PW = 4 * 8, I_VC = NB_S * 8, I_KC = 1024;
    constexpr int NITEMS = I_WIE + I_WOE + I_WIO + I_WOO + I_PW + I_VC + I_KC;
    for (int it = gw; it < NITEMS; it += NGW) {
        int r = it;
        if (r < I_WIE) { const int nb = r % (EVEN_IN / 32), kb = r / (EVEN_IN / 32); p0_transpose_item<true>(F.w_in_e, DM, EVEN_IN, F.WinE, 64 * kb, 32 * nb, g1_gbase(32 * nb), scr, lane); continue; } r -= I_WIE;
        if (r < I_WOE) { const int nb = r % 32, kb = r / 32; p0_transpose_item<true>(F.w_out_e, DM, DM, F.WoutE, 64 * kb, 32 * nb, 32 * nb, scr, lane); continue; } r -= I_WOE;
        if (r < I_WIO) { const int nb = r % (ODD_IN / 32), kb = r / (ODD_IN / 32); p0_transpose_item<true>(F.w_in_o, DM, ODD_IN, F.WinO, 64 * kb, 32 * nb, 32 * nb, scr, lane); continue; } r -= I_WIO;
        if (r < I_WOO) { const int nb = r % 32, kb = r / 32; p0_transpose_item<true>(F.w_out_o, DM, DM, F.WoutO, 64 * kb, 32 * nb, 32 * nb, scr, lane); continue; } r -= I_WOO;
        if (r < I_PW) { const int g = r >> 3, q = r & 7; p0_transpose_item<false>(F.pool_w + (size_t)g * 16384, 128, 128, F.PoolWT + (size_t)g * 16384, 64 * (q >> 2), 32 * (q & 3), 32 * (q & 3), scr, lane); continue; } r -= I_PW;
        if (r < I_VC) { const int sq = r >> 3, q = r & 7; p0_transpose_item<false>(F.cv + (size_t)sq * 16384, 128, 128, F.VTC + (size_t)sq * 16384, 64 * (q >> 2), 32 * (q & 3), 32 * (q & 3), scr, lane); continue; } r -= I_VC;
        {
            const float* src = F.ck + (size_t)r * 2048; bf16* dst = F.KC + (size_t)r * 2048;
#pragma unroll
            for (int j = 0; j < 4; ++j) { const int e = (j * 64 + lane) * 8; const f32x4 a = *(const f32x4*)(src + e), b = *(const f32x4*)(src + e + 4); *(v4u*)(dst + e) = pack8f(a, b); }
        }
    }
}

__device__ __forceinline__ const float* x_row(const Frame& F, int m) { return m < MP ? F.x_p + (size_t)m * DM : F.x_s + (size_t)(m - MP) * DM; }
__device__ __forceinline__ void prenorm_store(const Frame& F, const f32x4 (&v)[4], float rstd, const float* g, const float* md, bf16* hrow) {
    const int lane = F.lane;
#pragma unroll
    for (int j = 0; j < 4; ++j) { const int k = 4 * lane + 256 * j;
        const f32x4 gg = *(const f32x4*)(g + k), sh = *(const f32x4*)(md + k), sc = *(const f32x4*)(md + 1024 + k);
        const f32x4 h = v[j] * rstd * gg * (sc + 1.f) + sh;
        u32x2 o; o.x = pkbf(h[0], h[1]); o.y = pkbf(h[2], h[3]); *(u32x2*)(hrow + k) = o; }
}
__device__ __forceinline__ void p1_rows(Frame& F) {
    const int gw = F.vcu * NWAVES + F.wave, NGW = F.G * NWAVES, lane = F.lane;
    for (int m = gw; m < MT; m += NGW) {
        const f32x4* xr = (const f32x4*)x_row(F, m) + lane; f32x4 v[4]; float s = 0.f;
#pragma unroll
        for (int j = 0; j < 4; ++j) { v[j] = xr[64 * j]; s += (v[j][0] * v[j][0] + v[j][1] * v[j][1]) + (v[j][2] * v[j][2] + v[j][3] * v[j][3]); }
        const float rstd = rsqrtf(wave_sum(s) * (1.f / DM) + RMS_EPS);
        prenorm_store(F, v, rstd, F.g_pre_e, F.mods + (size_t)row_batch(m) * 3072, F.H + (size_t)m * DM);
    }
}
template <bool FINAL>
__device__ __forceinline__ void post_rows(Frame& F) {
    const int gw = F.vcu * NWAVES + F.wave, NGW = F.G * NWAVES, lane = F.lane;
    const float* gpost = FINAL ? F.g_post_o : F.g_post_e;
    for (int m = gw; m < MT; m += NGW) {
        const float* md = F.mods + (size_t)(FINAL ? 1 : 0) * NBT * 3072 + (size_t)row_batch(m) * 3072;
        const u32x2* orow = (const u32x2*)(F.OUT + (size_t)m * DM) + lane;
        float* yrow = F.out + O_Y + (size_t)m * DM;
        const f32x4* xr = (FINAL ? (const f32x4*)yrow : (const f32x4*)x_row(F, m)) + lane;
        f32x4 o[4], v[4]; float s = 0.f;
#pragma unroll
        for (int j = 0; j < 4; ++j) { const u32x2 w = orow[64 * j]; o[j] = (f32x4){bf_lo(w.x), bf_hi(w.x), bf_lo(w.y), bf_hi(w.y)}; v[j] = xr[64 * j];
            s += (o[j][0] * o[j][0] + o[j][1] * o[j][1]) + (o[j][2] * o[j][2] + o[j][3] * o[j][3]); }
        const float r0 = rsqrtf(wave_sum(s) * (1.f / DM) + RMS_EPS);
        float s1 = 0.f;
#pragma unroll
        for (int j = 0; j < 4; ++j) { const int k = 4 * lane + 256 * j;
            const f32x4 gg = *(const f32x4*)(gpost + k), gt = *(const f32x4*)(md + 2048 + k);
            v[j] = v[j] + gt * (o[j] * r0 * gg);
            *(f32x4*)(yrow + k) = v[j];
            s1 += (v[j][0] * v[j][0] + v[j][1] * v[j][1]) + (v[j][2] * v[j][2] + v[j][3] * v[j][3]); }
        if (!FINAL) {
            const float r1 = rsqrtf(wave_sum(s1) * (1.f / DM) + RMS_EPS);
            prenorm_store(F, v, r1, F.g_pre_o, F.mods + (size_t)NBT * 3072 + (size_t)row_batch(m) * 3072, F.H + (size_t)m * DM);
        }
    }
}

template <int NO>
__device__ __forceinline__ void p3_conv(const LAS unsigned char* st, LAS float* lnb, int base, int orow0, int cp, const float (&w0)[31], const float (&w1)[31], float b0, float b1) {
    float x0[NO + 30], x1[NO + 30];
#pragma unroll
    for (int q = 0; q < NO + 30; ++q) { const unsigned u = *(const LAS unsigned*)(st + (base + q) * 1024 + cp * 4); x0[q] = bf_lo(u); x1[q] = bf_hi(u); }
#pragma unroll
    for (int o = 0; o < NO; ++o) { float a0 = b0, a1 = b1;
#pragma unroll
        for (int j = 0; j < 31; ++j) { a0 += w0[j] * x0[o + j]; a1 += w1[j] * x1[o + j]; }
        *(LAS f32x2*)(lnb + (orow0 + o) * 512 + 2 * cp) = (f32x2){a0, a1}; }
}
__device__ __forceinline__ void ld8(const bf16* p, float (&f)[8]) { const v4u w = *(const v4u*)p; f[0] = bf_lo(w.x); f[1] = bf_hi(w.x); f[2] = bf_lo(w.y); f[3] = bf_hi(w.y); f[4] = bf_lo(w.z); f[5] = bf_hi(w.z); f[6] = bf_lo(w.w); f[7] = bf_hi(w.w); }
__device__ __forceinline__ void ld8f(const float* p, float (&f)[8]) { const f32x4 a = *(const f32x4*)p, b = *(const f32x4*)(p + 4); f[0] = a[0]; f[1] = a[1]; f[2] = a[2]; f[3] = a[3]; f[4] = b[0]; f[5] = b[1]; f[6] = b[2]; f[7] = b[3]; }
__device__ __forceinline__ void st8(bf16* p, const float (&f)[8]) { v4u w; w.x = pkbf(f[0], f[1]); w.y = pkbf(f[2], f[3]); w.z = pkbf(f[4], f[5]); w.w = pkbf(f[6], f[7]); *(v4u*)p = w; }
__device__ __forceinline__ void p3_mix0(Frame& F) {
    const bf16 *UA = F.A0, *GA = F.A1, *UB = F.A2, *SB = F.A3;
    LAS unsigned char* st = F.lds; LAS float* lnb = (LAS float*)(F.lds + P3_LN_OFF);
    const int tid = F.tid, lane = F.lane, cp = tid & 255, hf = tid >> 8;
    float w0[31], w1[31];
#pragma unroll
    for (int j = 0; j < 31; ++j) { const f32x2 t = *(const f32x2*)(F.conv_b_w + j * 512 + 2 * cp); w0[j] = t[0]; w1[j] = t[1]; }
    const f32x2 bb = *(const f32x2*)(F.conv_b_b + 2 * cp);
    for (int it = F.vcu; it < 576; it += F.G) {
        const bool smp = it >= 512; const int m0 = smp ? MP + (it - 512) * 16 : it * 32;
        if (!smp) { const int t0 = m0 & (SEQ - 1);
            for (int c = tid; c < 62 * 64; c += 512) { const int lr = c >> 6, c16 = c & 63; v4u v = {0u, 0u, 0u, 0u};
                if (t0 - 30 + lr >= 0) v = *(const v4u*)(UB + (size_t)(m0 - 30 + lr) * 512 + c16 * 8);
                *(LAS v4u*)(st + lr * 1024 + c16 * 16) = v; }
        } else { const int sq0 = (it - 512) * 2;
            for (int c = tid; c < 76 * 64; c += 512) { const int lr = c >> 6, c16 = c & 63, s = lr >= 38 ? 1 : 0, q = lr - 38 * s, sq = sq0 + s; v4u v;
                if (q < 30) { const float* p = F.st_b + ((size_t)sq * 30 + q) * 512 + c16 * 8; v = pack8f(*(const f32x4*)p, *(const f32x4*)(p + 4)); }
                else v = *(const v4u*)(UB + (size_t)(MP + sq * 8 + (q - 30)) * 512 + c16 * 8);
                *(LAS v4u*)(st + lr * 1024 + c16 * 16) = v; }
        }
        __syncthreads();
        if (!smp) p3_conv<16>(st, lnb, 16 * hf, 16 * hf, cp, w0, w1, bb[0], bb[1]);
        else      p3_conv<8>(st, lnb, 38 * hf, 8 * hf, cp, w0, w1, bb[0], bb[1]);
        __syncthreads();
        const int nrows = smp ? 16 : 32;
        for (int rr = F.wave; rr < nrows; rr += NWAVES) {
            const int m = m0 + rr, c8 = 8 * lane;
            float v[8]; { const LAS float* p = lnb + rr * 512 + c8; const f32x4 a = *(const LAS f32x4*)p, b = *(const LAS f32x4*)(p + 4); v[0] = a[0]; v[1] = a[1]; v[2] = a[2]; v[3] = a[3]; v[4] = b[0]; v[5] = b[1]; v[6] = b[2]; v[7] = b[3]; }
            float s = 0.f, q = 0.f;
#pragma unroll
            for (int i = 0; i < 8; ++i) { s += v[i]; q += v[i] * v[i]; }
            s = wave_sum(s); q = wave_sum(q);
            const float mean = s * (1.f / 512.f), var = fmaxf(q * (1.f / 512.f) - mean * mean, 0.f), rstd = rsqrtf(var + LNB_EPS);
            float g[8], b[8], sb[8], y[8];
            ld8f(F.ln_g + c8, g); ld8f(F.ln_b + c8, b); ld8(SB + (size_t)m * 512 + c8, sb);
#pragma unroll
            for (int i = 0; i < 8; ++i) y[i] = silu_f((v[i] - mean) * rstd * g[i] + b[i]) * sb[i];
            st8(F.MIX + (size_t)m * DM + 512 + c8, y);
            const int t = smp ? (rr & 7) : ((m0 & (SEQ - 1)) + rr), sq = smp ? (m - MP) >> 3 : 0;
            float u2[8], u1[8], u0[8], ga[8], wa0[8], wa1[8], wa2[8];
            ld8(UA + (size_t)m * 512 + c8, u2);
            if (t >= 1) ld8(UA + (size_t)(m - 1) * 512 + c8, u1);
            else if (smp) ld8f(F.st_a + ((size_t)sq * 2 + 1) * 512 + c8, u1);
            else {
#pragma unroll
                for (int i = 0; i < 8; ++i) u1[i] = 0.f; }
            if (t >= 2) ld8(UA + (size_t)(m - 2) * 512 + c8, u0);
            else if (smp) ld8f(F.st_a + ((size_t)sq * 2 + t) * 512 + c8, u0);
            else {
#pragma unroll
                for (int i = 0; i < 8; ++i) u0[i] = 0.f; }
            ld8(GA + (size_t)m * 512 + c8, ga); ld8f(F.conv_a_w + c8, wa0); ld8f(F.conv_a_w + 512 + c8, wa1); ld8f(F.conv_a_w + 1024 + c8, wa2);
#pragma unroll
            for (int i = 0; i < 8; ++i) y[i] = ga[i] * (wa0[i] * u0[i] + wa1[i] * u1[i] + wa2[i] * u2[i]);
            st8(F.MIX + (size_t)m * DM + c8, y);
        }
        __syncthreads();
    }
    constexpr int U_CAP = 4096 / 8, U_CAS = 131072 / 8, U_CBP = 61440 / 8, U_CBS = 1966080 / 8, U_ALL = U_CAP + U_CAS + U_CBP + U_CBS;
    for (int u = F.vcu * 512 + tid; u < U_ALL; u += F.G * 512) {
        int r = u; float f[8]; float* dst;
        if (r < U_CAP) { const int c8 = (r & 63) * 8, i = (r >> 6) & 1, b = r >> 7; ld8(UA + (size_t)(b * SEQ + SEQ - 2 + i) * 512 + c8, f); dst = F.out + O_CAP + (size_t)r * 8; }
        else if ((r -= U_CAP) < U_CAS) { const int c8 = (r & 63) * 8, i = (r >> 6) & 1, sq = r >> 7; ld8(UA + (size_t)(MP + sq * 8 + 6 + i) * 512 + c8, f); dst = F.out + O_CAS + (size_t)r * 8; }
        else if ((r -= U_CAS) < U_CBP) { const int c8 = (r & 63) * 8, q = (r >> 6) % 30, b = (r >> 6) / 30; ld8(UB + (size_t)(b * SEQ + SEQ - 30 + q) * 512 + c8, f); dst = F.out + O_CBP + (size_t)r * 8; }
        else { r -= U_CBP; const int c8 = (r & 63) * 8, q = (r >> 6) % 30, sq = (r >> 6) / 30;
            if (q < 22) ld8f(F.st_b + ((size_t)sq * 30 + 8 + q) * 512 + c8, f); else ld8(UB + (size_t)(MP + sq * 8 + (q - 22)) * 512 + c8, f);
            dst = F.out + O_CBS + (size_t)r * 8; }
        *(f32x4*)dst = (f32x4){f[0], f[1], f[2], f[3]}; *(f32x4*)(dst + 4) = (f32x4){f[4], f[5], f[6], f[7]};
    }
}

template <int G>
__device__ __forceinline__ void p7_pool_item(Frame& F, int ti) {
    constexpr int W = 2 << G;
    const bf16 *CU = F.A0, *SC = F.A1;
    const int lane = F.lane, r = lane & 31, hh = lane >> 5, m = ti * 32 + r; const bool smp = m >= MP;
    const int t = smp ? ((m - MP) & 7) : (m & (SEQ - 1)), sq = smp ? (m - MP) >> 3 : 0;
    const float inv = smp ? (1.f / W) : (1.f / (float)(t + 1 < W ? t + 1 : W));
    f32x16 acc[4];
#pragma unroll
    for (int dt = 0; dt < 4; ++dt) acc[dt] = (f32x16){0.f, 0.f, 0.f, 0.f, 0.f, 0.f, 0.f, 0.f, 0.f, 0.f, 0.f, 0.f, 0.f, 0.f, 0.f, 0.f};
    for (int s = 0; s < 8; ++s) {
        const int ch0 = G * 128 + 16 * s + 8 * hh;
        float sum[8], u[8], f[8];
        ld8(CU + (size_t)m * 512 + ch0, u);
#pragma unroll
        for (int i = 0; i < 8; ++i) sum[i] = u[i];
#pragma unroll
        for (int j = 1; j < W; ++j) {
            if (t - j >= 0) { ld8(CU + (size_t)(m - j) * 512 + ch0, f);
#pragma unroll
                for (int i = 0; i < 8; ++i) sum[i] += f[i]; }
            else if (smp) { ld8f(F.st_c + ((size_t)sq * 15 + 15 + (t - j)) * 512 + ch0, f);
#pragma unroll
                for (int i = 0; i < 8; ++i) sum[i] += f[i]; }
        }
        const v4u pw = {pkbf(sum[0] * inv - u[0], sum[1] * inv - u[1]), pkbf(sum[2] * inv - u[2], sum[3] * inv - u[3]), pkbf(sum[4] * inv - u[4], sum[5] * inv - u[5]), pkbf(sum[6] * inv - u[6], sum[7] * inv - u[7])};
        const bf16x8 bfrag = __builtin_bit_cast(bf16x8, pw);
#pragma unroll
        for (int dt = 0; dt < 4; ++dt) { const bf16x8 af = *(const bf16x8*)(F.PoolWT + ((size_t)(G * 128 + 32 * dt + r)) * 128 + 16 * s + 8 * hh);
            acc[dt] = __builtin_amdgcn_mfma_f32_32x32x16_bf16(af, bfrag, acc[dt], 0, 0, 0); }
    }
#pragma unroll
    for (int dt = 0; dt < 4; ++dt)
#pragma unroll
        for (int rq = 0; rq < 4; ++rq) { const int ch = G * 128 + 32 * dt + 8 * rq + 4 * hh;
            const f32x4 ps = *(const f32x4*)(F.pool_scale + ch); const u32x2 sc = *(const u32x2*)(SC + (size_t)m * 512 + ch);
            u32x2 o; o.x = pkbf(acc[dt][4 * rq + 0] * ps[0] * bf_lo(sc.x), acc[dt][4 * rq + 1] * ps[1] * bf_hi(sc.x)); o.y = pkbf(acc[dt][4 * rq + 2] * ps[2] * bf_lo(sc.y), acc[dt][4 * rq + 3] * ps[3] * bf_hi(sc.y));
            *(u32x2*)(F.MIX + (size_t)m * DM + ch) = o; }
}
__device__ __forceinline__ int key_of(int r) { return 16 * ((r >> 2) & 1) + 8 * (r >> 4) + 4 * ((r >> 3) & 1) + (r & 3); }
__device__ __forceinline__ void p7_attn_item(Frame& F, int sidx) {
    const bf16 *Q = F.A2, *SD = F.A3;
    const int lane = F.lane, r = lane & 31, hh = lane >> 5;
    const bool smp = sidx >= 4096;
    int h, qi, mq, kt_first;
    int b = 0, t0 = 0, sq = 0, g;
    if (!smp) { h = sidx & 7; const int qb = (sidx >> 3) & 127; b = sidx >> 10; t0 = qb * 32; qi = r; mq = b * SEQ + t0 + r; g = h >> 2; kt_first = t0 >= 128 ? 0 : 4 - (t0 >> 5); }
    else { const int si = sidx - 4096; sq = si >> 1; g = si & 1; h = 4 * g + (r >> 3); qi = r & 7; mq = MP + sq * 8 + qi; kt_first = 0; }
    const int kr = key_of(r);
    bf16x8 qf[4];
#pragma unroll
    for (int s = 0; s < 4; ++s) qf[s] = *(const bf16x8*)(Q + (size_t)mq * 512 + h * 64 + 16 * s + 8 * hh);
    const float slope2 = exp2f(-(float)(h + 1)) * LOG2E, sink2 = F.sinks[h] * LOG2E;
    f32x16 S[5];
#pragma unroll
    for (int kt = 0; kt < 5; ++kt) {
        if (kt >= kt_first) {
            const bf16* kbase;
            if (!smp) kbase = F.K + (size_t)(b * SEQ + t0 - 128 + 32 * kt + kr) * 128 + g * 64 + 8 * hh;
            else if (kt < 4) kbase = F.KC + (size_t)((sq * 128 + 32 * kt + kr)) * 128 + g * 64 + 8 * hh;
            else kbase = F.K + (size_t)(MP + sq * 8 + kr) * 128 + g * 64 + 8 * hh;
            bf16x8 kf[4];
#pragma unroll
            for (int s = 0; s < 4; ++s) kf[s] = *(const bf16x8*)(kbase + 16 * s);
            f32x16 a = (f32x16){0.f, 0.f, 0.f, 0.f, 0.f, 0.f, 0.f, 0.f, 0.f, 0.f, 0.f, 0.f, 0.f, 0.f, 0.f, 0.f};
#pragma unroll
            for (int s = 0; s < 4; ++s) a = __builtin_amdgcn_mfma_f32_32x32x16_bf16(kf[s], qf[s], a, 0, 0, 0);
#pragma unroll
            for (int q = 0; q < 16; ++q) { const int dist = qi + 128 - 32 * kt - 16 * hh - q; a[q] = (dist >= 0 && dist <= 127) ? a[q] - slope2 * (float)dist : -INFINITY; }
            S[kt] = a;
        } else {
#pragma unroll
            for (int q = 0; q < 16; ++q) S[kt][q] = -INFINITY;
        }
    }
    float mx = sink2;
#pragma unroll
    for (int kt = 0; kt < 5; ++kt)
#pragma unroll
        for (int q = 0; q < 16; ++q) mx = fmaxf(mx, S[kt][q]);
    mx = fmaxf(mx, __shfl_xor(mx, 32));
    float sum = 0.f;
#pragma unroll
    for (int kt = 0; kt < 5; ++kt)
#pragma unroll
        for (int q = 0; q < 16; ++q) { const float p = __builtin_amdgcn_exp2f(S[kt][q] - mx); S[kt][q] = p; sum += p; }
    sum += __shfl_xor(sum, 32);
    const float inv = __builtin_amdgcn_rcpf(sum + __builtin_amdgcn_exp2f(sink2 - mx));
    f32x16 O[2];
    O[0] = (f32x16){0.f, 0.f, 0.f, 0.f, 0.f, 0.f, 0.f, 0.f, 0.f, 0.f, 0.f, 0.f, 0.f, 0.f, 0.f, 0.f}; O[1] = O[0];
#pragma unroll
    for (int kt = 0; kt < 5; ++kt) {
        if (kt >= kt_first) {
            const bf16* vbase; size_t vld;
            if (!smp) { vbase = F.VT + (size_t)(g * 64 + r) * VT_LD + (b * SEQ + t0 - 128 + 32 * kt + 16 * hh); vld = VT_LD; }
            else if (kt < 4) { vbase = F.VTC + ((size_t)(sq * 128 + g * 64 + r)) * 128 + 32 * kt + 16 * hh; vld = 128; }
            else { vbase = F.VT + (size_t)(g * 64 + r) * VT_LD + (MP + sq * 8 + 16 * hh); vld = VT_LD; }
#pragma unroll
            for (int sp = 0; sp < 2; ++sp) {
                const v4u pw = {pkbf(S[kt][8 * sp + 0], S[kt][8 * sp + 1]), pkbf(S[kt][8 * sp + 2], S[kt][8 * sp + 3]), pkbf(S[kt][8 * sp + 4], S[kt][8 * sp + 5]), pkbf(S[kt][8 * sp + 6], S[kt][8 * sp + 7])};
                const bf16x8 pf = __builtin_bit_cast(bf16x8, pw);
#pragma unroll
                for (int dt = 0; dt < 2; ++dt) { const bf16x8 vf = *(const bf16x8*)(vbase + (size_t)(32 * dt) * vld + 8 * sp);
                    O[dt] = __builtin_amdgcn_mfma_f32_32x32x16_bf16(vf, pf, O[dt], 0, 0, 0); }
            }
        }
    }
#pragma unroll
    for (int dt = 0; dt < 2; ++dt)
#pragma unroll
        for (int rq = 0; rq < 4; ++rq) { const int d0 = h * 64 + 32 * dt + 8 * rq + 4 * hh;
            const u32x2 sd = *(const u32x2*)(SD + (size_t)mq * 512 + d0);
            u32x2 o; o.x = pkbf(O[dt][4 * rq + 0] * inv * bf_lo(sd.x), O[dt][4 * rq + 1] * inv * bf_hi(sd.x)); o.y = pkbf(O[dt][4 * rq + 2] * inv * bf_lo(sd.y), O[dt][4 * rq + 3] * inv * bf_hi(sd.y));
            *(u32x2*)(F.MIX + (size_t)mq * DM + 512 + d0) = o; }
}
__device__ __forceinline__ void p7_mix1(Frame& F) {
    const int gw = F.vcu * NWAVES + F.wave, NGW = F.G * NWAVES;
    constexpr int N_ATT = 4096 + 256, N_POOL = (MT / 32) * 4;
    for (int it = gw; it < N_ATT; it += NGW) p7_attn_item(F, it);
    for (int it = gw + ((N_ATT + NGW - 1 - gw) / NGW) * NGW - N_ATT; it < N_POOL; it += NGW) {
        const int ti = it >> 2, g = it & 3;
        if (g == 0) p7_pool_item<0>(F, ti); else if (g == 1) p7_pool_item<1>(F, ti); else if (g == 2) p7_pool_item<2>(F, ti); else p7_pool_item<3>(F, ti);
    }
    const bf16* CU = F.A0;
    constexpr int U_PCP = 30720 / 8, U_PCS = 983040 / 8, U_WKP = 65536 / 8, U_WKS = 2097152 / 8, U_ALL = U_PCP + U_PCS + U_WKP + U_WKS;
    for (int u = F.vcu * 512 + F.tid; u < U_ALL; u += F.G * 512) {
        int r = u; float f[8]; float* dst;
        if (r < U_PCP) { const int c8 = (r & 63) * 8, q = (r >> 6) % 15, b = (r >> 6) / 15; ld8(CU + (size_t)(b * SEQ + SEQ - 15 + q) * 512 + c8, f); dst = F.out + O_PCP + (size_t)r * 8; }
        else if ((r -= U_PCP) < U_PCS) { const int c8 = (r & 63) * 8, q = (r >> 6) % 15, sq = (r >> 6) / 15;
            if (q < 7) ld8f(F.st_c + ((size_t)sq * 15 + 8 + q) * 512 + c8, f); else ld8(CU + (size_t)(MP + sq * 8 + (q - 7)) * 512 + c8, f);
            dst = F.out + O_PCS + (size_t)r * 8; }
        else if ((r -= U_PCS) < U_WKP) { const int c8 = (r & 15) * 8, q = (r >> 4) & 127, b = r >> 11; ld8(F.K + (size_t)(b * SEQ + SEQ - 128 + q) * 128 + c8, f); dst = F.out + O_WKP + (size_t)r * 8; }
        else { r -= U_WKP; const int c8 = (r & 15) * 8, q = (r >> 4) & 127, sq = r >> 11;
            if (q < 120) ld8f(F.ck + ((size_t)sq * 128 + 8 + q) * 128 + c8, f); else ld8(F.K + (size_t)(MP + sq * 8 + (q - 120)) * 128 + c8, f);
            dst = F.out + O_WKS + (size_t)r * 8; }
        *(f32x4*)dst = (f32x4){f[0], f[1], f[2], f[3]}; *(f32x4*)(dst + 4) = (f32x4){f[4], f[5], f[6], f[7]};
    }
    for (int e = F.vcu * 512 + F.tid; e < 65536 + 2097152; e += F.G * 512) {
        if (e < 65536) { const int c = e & 127, q = (e >> 7) & 127, b = e >> 14; F.out[O_WVP + e] = bf_lo((unsigned)F.VT[(size_t)c * VT_LD + b * SEQ + SEQ - 128 + q]); }
        else { const int r = e - 65536, c = r & 127, q = (r >> 7) & 127, sq = r >> 14;
            F.out[O_WVS + r] = q < 120 ? F.cv[((size_t)sq * 128 + 8 + q) * 128 + c] : bf_lo((unsigned)F.VT[(size_t)c * VT_LD + MP + sq * 8 + (q - 120)]); }
    }
}

struct Args { const float* in[29]; float* out; unsigned char* ws; int ph_lo, ph_hi; };
constexpr int N_PHASES = 10;
__global__ void __launch_bounds__(NWAVES * 64, 2) fwd_mega(Args args) {
    extern __shared__ __attribute__((aligned(16))) unsigned char lds[];
    Frame F;
    F.lds = (LAS unsigned char*)lds;
    F.MISC = (volatile LAS unsigned*)(F.lds + MISC_OFF);
    F.tid = threadIdx.x; F.lane = F.tid & 63; F.wave = __builtin_amdgcn_readfirstlane(F.tid >> 6);
    F.G = gridDim.x; { const int bx = blockIdx.x; F.vcu = (F.G % 8 == 0) ? (bx % 8) * (F.G / 8) + bx / 8 : bx; }
    unsigned char* ws = args.ws;
    F.ctl = (gu32*)(ws + WS_CTL);
    F.x_p = args.in[0]; F.x_s = args.in[1]; F.st_a = args.in[2]; F.st_b = args.in[3]; F.st_c = args.in[4]; F.ck = args.in[5]; F.cv = args.in[6]; F.c_p = args.in[7]; F.c_s = args.in[8];
    F.w_mod_e = args.in[9]; F.b_mod_e = args.in[10]; F.g_pre_e = args.in[11]; F.g_post_e = args.in[12]; F.w_in_e = args.in[13]; F.conv_a_w = args.in[14]; F.conv_b_w = args.in[15];
    F.conv_b_b = args.in[16]; F.ln_g = args.in[17]; F.ln_b = args.in[18]; F.w_out_e = args.in[19];
    F.w_mod_o = args.in[20]; F.b_mod_o = args.in[21]; F.g_pre_o = args.in[22]; F.g_post_o = args.in[23]; F.w_in_o = args.in[24]; F.pool_w = args.in[25]; F.pool_scale = args.in[26];
    F.sinks = args.in[27]; F.w_out_o = args.in[28]; F.out = args.out;
    F.mods = (float*)(ws + WS_MODS);
    F.WinE = (bf16*)(ws + WS_WINE); F.WoutE = (bf16*)(ws + WS_WOUTE); F.WinO = (bf16*)(ws + WS_WINO); F.WoutO = (bf16*)(ws + WS_WOUTO); F.PoolWT = (bf16*)(ws + WS_POOLW);
    F.KC = (bf16*)(ws + WS_KC); F.VTC = (bf16*)(ws + WS_VTC);
    F.H = (bf16*)(ws + WS_H); F.MIX = (bf16*)(ws + WS_MIX); F.OUT = (bf16*)(ws + WS_OUT);
    F.A0 = (bf16*)(ws + WS_ACT); F.A1 = (bf16*)(ws + WS_ACT + ACT_STRIDE); F.A2 = (bf16*)(ws + WS_ACT + 2 * ACT_STRIDE); F.A3 = (bf16*)(ws + WS_ACT + 3 * ACT_STRIDE);
    F.K = (bf16*)(ws + WS_K); F.VT = (bf16*)(ws + WS_VT);
    for (int u = F.tid; u < (LDS_BYTES - LDSCTL_OFF) / 4; u += NWAVES * 64) ((LAS unsigned*)(F.lds + LDSCTL_OFF))[u] = 0u;
    __syncthreads();
    const int lo = args.ph_lo, hi = args.ph_hi;
    const bool multi = (hi - lo) > 1;
    XcdBarrier bar; bar.bar = (unsigned*)(F.ctl + CW_BAR); bar.x = 0; bar.st = nullptr;
    if (multi) bar = xcd_barrier_post((unsigned*)(F.ctl + CW_BAR), F.MISC + 8);
#ifndef PH_MASK
#define PH_MASK 0x3ff
#endif
#define IN(k) (((PH_MASK >> (k)) & 1) && lo <= (k) && (k) < hi)
#define SEAM(k) do { if (IN(k) && IN((k) + 1)) xcd_barrier(bar); } while (0)

    if (IN(0)) { p0_prologue(F); } SEAM(0);
    if (IN(1)) { p1_rows(F); } SEAM(1);
    if (IN(2)) {
        pg8::Gemm g{F.H, F.WinE, MT, EVEN_IN, DM}; pg8::StaticOrder S; S.init(MT, EVEN_IN, F.G, (int)blockIdx.x);
        pg8::EpiG1 E{F.A0, ACT_STRIDE / 2};
        pg8::gemm_phase<pg8::EpiG1, pg8::StaticOrder, true, true>(F.lds, g, S, E);
    } SEAM(2);
    if (IN(3)) { p3_mix0(F); } SEAM(3);
    if (IN(4)) {
        pg8::Gemm g{F.MIX, F.WoutE, MT, DM, DM}; pg8::StaticOrder S; S.init(MT, DM, F.G, (int)blockIdx.x);
        pg8::EpiPlain E{F.OUT, DM};
        pg8::gemm_phase<pg8::EpiPlain, pg8::StaticOrder, true, true>(F.lds, g, S, E);
    } SEAM(4);
    if (IN(5)) { post_rows<false>(F); } SEAM(5);
    if (IN(6)) {
        pg8::Gemm g{F.H, F.WinO, MT, ODD_IN, DM}; pg8::StaticOrder S; S.init(MT, ODD_IN, F.G, (int)blockIdx.x);
        pg8::EpiG3 E{F.A0, F.K, F.VT, ACT_STRIDE / 2, VT_LD, 0.125f * LOG2E};
        pg8::gemm_phase<pg8::EpiG3, pg8::StaticOrder, true, true>(F.lds, g, S, E);
    } SEAM(6);
    if (IN(7)) { p7_mix1(F); } SEAM(7);
    if (IN(8)) {
        pg8::Gemm g{F.MIX, F.WoutO, MT, DM, DM}; pg8::StaticOrder S; S.init(MT, DM, F.G, (int)blockIdx.x);
        pg8::EpiPlain E{F.OUT, DM};
        pg8::gemm_phase<pg8::EpiPlain, pg8::StaticOrder, true, true>(F.lds, g, S, E);
    } SEAM(8);
    if (IN(9)) { post_rows<true>(F); }
#undef IN
#undef SEAM
}

#ifndef MK_PER_PHASE
#define MK_PER_PHASE 0
#endif
extern "C" void kernel_launch(void* const* d_in, const int* in_sizes, int n_in, void* d_out, int out_size, void* d_ws, size_t ws_size, hipStream_t stream) {
    static int grid = 0;
    if (grid == 0) {
        if (n_in != 29 || in_sizes[0] != MP * DM || (size_t)out_size != O_END || ws_size < WS_END) { fprintf(stderr, "kernel_launch: unexpected shapes (n_in %d in0 %d out %d ws %zu)\n", n_in, n_in > 0 ? in_sizes[0] : -1, out_size, ws_size); grid = -1; return; }
        int dev = 0, cus = 0;
        if (hipGetDevice(&dev) != hipSuccess || hipDeviceGetAttribute(&cus, hipDeviceAttributeMultiprocessorCount, dev) != hipSuccess) { grid = -1; return; }
        if (hipFuncSetAttribute((const void*)fwd_mega, hipFuncAttributeMaxDynamicSharedMemorySize, LDS_BYTES) != hipSuccess) { fprintf(stderr, "kernel_launch: hipFuncSetAttribute failed\n"); grid = -1; return; }
        int per_cu = 0;
        if (hipOccupancyMaxActiveBlocksPerMultiprocessor(&per_cu, (const void*)fwd_mega, NWAVES * 64, LDS_BYTES) != hipSuccess || per_cu < 1) fprintf(stderr, "kernel_launch: occupancy query says %d\n", per_cu);
        (void)hipGetLastError();
        grid = cus;
    }
    if (grid < 0) return;
    (void)hipMemsetAsync((char*)d_ws + WS_CTL, 0, CTL_ZERO_BYTES, stream);
    Args a{};
    for (int i = 0; i < 29; ++i) a.in[i] = (const float*)d_in[i];
    a.out = (float*)d_out; a.ws = (unsigned char*)d_ws;
#if MK_PER_PHASE
    for (int p = 0; p < N_PHASES; ++p) { a.ph_lo = p; a.ph_hi = p + 1; hipLaunchKernelGGL(fwd_mega, dim3(grid), dim3(NWAVES * 64), LDS_BYTES, stream, a); }
#else
    a.ph_lo = 0; a.ph_hi = N_PHASES;
    hipLaunchKernelGGL(fwd_mega, dim3(grid), dim3(NWAVES * 64), LDS_BYTES, stream, a);
#endif
}
```
